# Optimizing an MI355X kernel written in HIP

```python
import math
import jax, jax.numpy as jnp
from jax import lax
import numpy as np

D_MODEL = 1024
BATCH = 8
SEQ = 2048
DEPTH = 4

HEAD_DIM = 64
N_HEADS_FOX = 8
N_HEADS_DIFF = 4
DIFF_V_DIM = 2 * HEAD_DIM
N_HEADS_DIL = 16
DILATED_CONFIGS = ((128, 1), (512, 4), (2048, 16))
ROT_DIM = HEAD_DIM // 4
ROPE_THETA = 500000.0
Q_BLOCK = 128
W_BLOCK = 128
NORM_EPS = 1e-6
WIDTH_FOX = N_HEADS_FOX * HEAD_DIM
DIFF_QK_WIDTH = N_HEADS_DIFF * 2 * HEAD_DIM
WIDTH_DIFF = N_HEADS_DIFF * DIFF_V_DIM
WIDTH_DIL = N_HEADS_DIL * HEAD_DIM
EVEN_IN = 4 * WIDTH_FOX + N_HEADS_FOX + 2 * DIFF_QK_WIDTH + 2 * WIDTH_DIFF
ODD_IN = 4 * WIDTH_DIL

kernel_name = 'hybrid_fox_diff_dilated_block'


def rms_norm(x, w):
    xf = x.astype(jnp.float32)
    var = jnp.mean(xf * xf, axis=-1, keepdims=True)
    return (xf * lax.rsqrt(var + NORM_EPS) * w.astype(jnp.float32)).astype(x.dtype)


def split_heads(t, n_heads, dh):
    b, s, _ = t.shape
    return t.reshape(b, s, n_heads, dh).transpose(0, 2, 1, 3)


def merge_heads(t):
    b, h, s, dh = t.shape
    return t.transpose(0, 2, 1, 3).reshape(b, s, h * dh)


def partial_rope(t, positions):
    inv_freq = 1.0 / (ROPE_THETA ** (jnp.arange(0, ROT_DIM, 2, dtype=jnp.float32) / ROT_DIM))
    ang = positions.astype(jnp.float32)[:, None, :, None] * inv_freq
    cos, sin = jnp.cos(ang), jnp.sin(ang)
    tr = t[..., :ROT_DIM].astype(jnp.float32)
    t1, t2 = tr[..., :ROT_DIM // 2], tr[..., ROT_DIM // 2:]
    rot = jnp.concatenate([t1 * cos - t2 * sin, t2 * cos + t1 * sin], axis=-1).astype(t.dtype)
    return jnp.concatenate([rot, t[..., ROT_DIM:]], axis=-1)


def fox_attention(q, k, v, log_f):
    b, h, s, dh = q.shape
    F = jnp.cumsum(log_f.astype(jnp.float32), axis=-1)
    scale = dh ** -0.5
    kpos = jnp.arange(s)

    def block(i):
        start = i * Q_BLOCK
        qb = lax.dynamic_slice_in_dim(q, start, Q_BLOCK, axis=2)
        Fq = lax.dynamic_slice_in_dim(F, start, Q_BLOCK, axis=2)
        sc = jnp.einsum('bhqd,bhkd->bhqk', qb, k, preferred_element_type=jnp.float32) * scale
        sc = sc + (Fq[..., :, None] - F[..., None, :])
        causal = kpos[None, :] <= (start + jnp.arange(Q_BLOCK))[:, None]
        p = jax.nn.softmax(jnp.where(causal, sc, -jnp.inf), axis=-1)
        return jnp.einsum('bhqk,bhkd->bhqd', p.astype(v.dtype), v)

    o = lax.map(block, jnp.arange(s // Q_BLOCK))
    return o.transpose(1, 2, 0, 3, 4).reshape(b, h, s, v.shape[-1])


def diff_attention(q1, q2, k1, k2, v, lam):
    b, h, s, dh = q1.shape
    scale = dh ** -0.5
    kpos = jnp.arange(s)

    def block(i):
        start = i * Q_BLOCK
        qb1 = lax.dynamic_slice_in_dim(q1, start, Q_BLOCK, axis=2)
        qb2 = lax.dynamic_slice_in_dim(q2, start, Q_BLOCK, axis=2)
        causal = kpos[None, :] <= (start + jnp.arange(Q_BLOCK))[:, None]
        s1 = jnp.einsum('bhqd,bhkd->bhqk', qb1, k1, preferred_element_type=jnp.float32) * scale
        s2 = jnp.einsum('bhqd,bhkd->bhqk', qb2, k2, preferred_element_type=jnp.float32) * scale
        p1 = jax.nn.softmax(jnp.where(causal, s1, -jnp.inf), axis=-1)
        p2 = jax.nn.softmax(jnp.where(causal, s2, -jnp.inf), axis=-1)
        p = p1 - lam * p2
        return jnp.einsum('bhqk,bhkd->bhqd', p.astype(v.dtype), v)

    o = lax.map(block, jnp.arange(s // Q_BLOCK))
    return o.transpose(1, 2, 0, 3, 4).reshape(b, h, s, v.shape[-1])


def dilated_window_branch(q, k, v, dilation, n_back):
    b, h, s, dh = q.shape
    L = s // dilation
    Lp = -(-L // W_BLOCK) * W_BLOCK
    nb = Lp // W_BLOCK

    def to_blocks(t):
        t = t.reshape(b, h, L, dilation, t.shape[-1]).transpose(0, 1, 3, 2, 4)
        t = jnp.pad(t, ((0, 0), (0, 0), (0, 0), (0, Lp - L), (0, 0)))
        return t.reshape(b, h, dilation, nb, W_BLOCK, t.shape[-1])

    def band(t):
        prev = jnp.pad(t[:, :, :, :-1], ((0, 0), (0, 0), (0, 0), (1, 0), (0, 0), (0, 0)))
        return jnp.concatenate([prev, t], axis=4)

    qb = to_blocks(q)
    kband = band(to_blocks(k))
    vband = band(to_blocks(v))
    sc = jnp.einsum('bhrnqd,bhrnkd->bhrnqk', qb, kband, preferred_element_type=jnp.float32) * dh ** -0.5
    qi = jnp.arange(W_BLOCK)
    ki = jnp.arange(2 * W_BLOCK) - W_BLOCK
    dist = qi[:, None] - ki[None, :]
    in_window = (dist >= 0) & (dist <= n_back)
    key_exists = (jnp.arange(nb)[:, None, None] * W_BLOCK + ki[None, None, :]) >= 0
    mask = in_window[None] & key_exists
    sc = jnp.where(mask, sc, -jnp.inf)
    m = jnp.max(sc, axis=-1, keepdims=True)
    e = jnp.exp(sc - m)
    l = jnp.sum(e, axis=-1, keepdims=True)
    o = jnp.einsum('bhrnqk,bhrnkd->bhrnqd', (e / l).astype(v.dtype), vband)

    def from_blocks(t):
        t = t.reshape(b, h, dilation, Lp, t.shape[-1])[:, :, :, :L]
        return t.transpose(0, 1, 3, 2, 4).reshape(b, h, s, t.shape[-1])

    return from_blocks(o), from_blocks(m), from_blocks(l)


def dilated_mixture(q, k, v):
    branches = [dilated_window_branch(q, k, v, d, w // d) for (w, d) in DILATED_CONFIGS]
    big_m = branches[0][1]
    for _, m_i, _ in branches[1:]:
        big_m = jnp.maximum(big_m, m_i)
    num = 0.0
    den = 0.0
    for o_i, m_i, l_i in branches:
        w_i = l_i * jnp.exp(m_i - big_m)
        num = num + w_i * o_i.astype(jnp.float32)
        den = den + w_i
    return (num / den).astype(v.dtype)


def fox_diff_mixer(h, positions, w_in, b_forget, lam_q1, lam_k1, lam_q2, lam_k2, subln, w_out, layer_idx):
    b, s, _ = h.shape
    proj = jnp.einsum('bsd,de->bse', h, w_in)
    sizes = (WIDTH_FOX, WIDTH_FOX, WIDTH_FOX, N_HEADS_FOX, WIDTH_FOX,
             DIFF_QK_WIDTH, DIFF_QK_WIDTH, WIDTH_DIFF, WIDTH_DIFF)
    cuts = [int(v) for v in np.cumsum(sizes)[:-1]]
    qa, ka, va, fa, ga, qd, kd, vd, gd = jnp.split(proj, cuts, axis=-1)
    log_f = jax.nn.log_sigmoid((fa + b_forget).astype(jnp.float32)).transpose(0, 2, 1)
    oa = fox_attention(split_heads(qa, N_HEADS_FOX, HEAD_DIM), split_heads(ka, N_HEADS_FOX, HEAD_DIM),
                       split_heads(va, N_HEADS_FOX, HEAD_DIM), log_f)
    out_a = merge_heads(oa) * jax.nn.silu(ga)
    def sub_heads(t):
        return t.reshape(b, s, N_HEADS_DIFF, 2, HEAD_DIM).transpose(0, 2, 3, 1, 4)
    qd2, kd2 = sub_heads(qd), sub_heads(kd)
    q1, q2 = partial_rope(qd2[:, :, 0], positions), partial_rope(qd2[:, :, 1], positions)
    k1, k2 = partial_rope(kd2[:, :, 0], positions), partial_rope(kd2[:, :, 1], positions)
    lam_init = 0.8 - 0.6 * math.exp(-0.3 * layer_idx)
    lam = (jnp.exp(jnp.sum(lam_q1.astype(jnp.float32) * lam_k1.astype(jnp.float32)))
           - jnp.exp(jnp.sum(lam_q2.astype(jnp.float32) * lam_k2.astype(jnp.float32))) + lam_init)
    od = diff_attention(q1, q2, k1, k2, split_heads(vd, N_HEADS_DIFF, DIFF_V_DIM), lam)
    od = rms_norm(od, subln) * (1.0 - lam_init)
    out_b = merge_heads(od) * jax.nn.silu(gd)
    return jnp.einsum('bse,ed->bsd', jnp.concatenate([out_a, out_b], axis=-1), w_out)


def dilated_mixer(h, positions, w_in, w_out):
    proj = jnp.einsum('bsd,de->bse', h, w_in)
    qc, kc, vc, gc = jnp.split(proj, 4, axis=-1)
    q = partial_rope(split_heads(qc, N_HEADS_DIL, HEAD_DIM), positions)
    k = partial_rope(split_heads(kc, N_HEADS_DIL, HEAD_DIM), positions)
    v = split_heads(vc, N_HEADS_DIL, HEAD_DIM)
    oc = merge_heads(dilated_mixture(q, k, v)) * jax.nn.silu(gc)
    return jnp.einsum('bse,ed->bsd', oc, w_out)


def setup_inputs(seed: int = 0) -> dict:
    key = jax.random.key(seed)
    ks = jax.random.split(key, 18)
    n_even = (DEPTH + 1) // 2
    n_odd = DEPTH // 2

    def nrm(k, shape, scale):
        return jax.random.normal(k, shape, jnp.float32) * scale

    x = nrm(ks[0], (BATCH, SEQ, D_MODEL), 1.0)
    c = nrm(ks[1], (BATCH, D_MODEL), 1.0)
    offsets = jax.random.randint(ks[2], (BATCH, 1), 0, 4096, dtype=jnp.int32)
    positions = (offsets + jnp.arange(SEQ, dtype=jnp.int32)[None, :]).astype(jnp.int32)
    norm_pre = 1.0 + nrm(ks[3], (DEPTH, D_MODEL), 0.1)
    norm_post = 1.0 + nrm(ks[4], (DEPTH, D_MODEL), 0.1)
    ada_w = nrm(ks[5], (DEPTH, D_MODEL, 3 * D_MODEL), D_MODEL ** -0.5)
    ada_b = nrm(ks[6], (DEPTH, 3 * D_MODEL), 0.02)
    ev_w_in = nrm(ks[7], (n_even, D_MODEL, EVEN_IN), D_MODEL ** -0.5)
    ev_b_forget = 2.0 + nrm(ks[8], (n_even, N_HEADS_FOX), 0.5)
    ev_lambda_q1 = nrm(ks[9], (n_even, HEAD_DIM), 0.1)
    ev_lambda_k1 = nrm(ks[10], (n_even, HEAD_DIM), 0.1)
    ev_lambda_q2 = nrm(ks[11], (n_even, HEAD_DIM), 0.1)
    ev_lambda_k2 = nrm(ks[12], (n_even, HEAD_DIM), 0.1)
    ev_subln = 1.0 + nrm(ks[13], (n_even, DIFF_V_DIM), 0.1)
    ev_w_out = nrm(ks[14], (n_even, WIDTH_FOX + WIDTH_DIFF, D_MODEL), (WIDTH_FOX + WIDTH_DIFF) ** -0.5)
    od_w_in = nrm(ks[15], (n_odd, D_MODEL, ODD_IN), D_MODEL ** -0.5)
    od_w_out = nrm(ks[16], (n_odd, WIDTH_DIL, D_MODEL), WIDTH_DIL ** -0.5)
    return {'x': x, 'c': c, 'positions': positions, 'norm_pre': norm_pre, 'norm_post': norm_post,
            'ada_w': ada_w, 'ada_b': ada_b, 'ev_w_in': ev_w_in, 'ev_b_forget': ev_b_forget,
            'ev_lambda_q1': ev_lambda_q1, 'ev_lambda_k1': ev_lambda_k1,
            'ev_lambda_q2': ev_lambda_q2, 'ev_lambda_k2': ev_lambda_k2, 'ev_subln': ev_subln,
            'ev_w_out': ev_w_out, 'od_w_in': od_w_in, 'od_w_out': od_w_out}


def reference(x, c, positions, norm_pre, norm_post, ada_w, ada_b, ev_w_in, ev_b_forget,
              ev_lambda_q1, ev_lambda_k1, ev_lambda_q2, ev_lambda_k2, ev_subln, ev_w_out,
              od_w_in, od_w_out):
    cond = jax.nn.silu(c)
    for layer in range(DEPTH):
        mod = jnp.einsum('bd,de->be', cond, ada_w[layer]) + ada_b[layer]
        shift, scale, gate = jnp.split(mod, 3, axis=-1)
        h = rms_norm(x, norm_pre[layer]) * (1.0 + scale[:, None, :]) + shift[:, None, :]
        if layer % 2 == 0:
            i = layer // 2
            y = fox_diff_mixer(h, positions, ev_w_in[i], ev_b_forget[i], ev_lambda_q1[i], ev_lambda_k1[i],
                               ev_lambda_q2[i], ev_lambda_k2[i], ev_subln[i], ev_w_out[i], layer)
        else:
            j = layer // 2
            y = dilated_mixer(h, positions, od_w_in[j], od_w_out[j])
        x = x + gate[:, None, :] * rms_norm(y, norm_post[layer])
    return x
```

```cpp
#include <hip/hip_runtime.h>
#include <cmath>
#include <cstdio>

namespace {
constexpr int D = 1024, NB = 8, S = 2048, NL = 4, M = NB * S;
constexpr int EV_IN = 4104, OD_IN = 4096;
constexpr int CH_B = 2, CH_M = CH_B * S;
constexpr float EPS = 1e-6f;

struct Rope { float f[8]; };

__device__ __forceinline__ float siluf(float v) { return v / (1.f + expf(-v)); }
__device__ __forceinline__ float wave_sum(float v) {
#pragma unroll
    for (int o = 1; o < 64; o <<= 1) v += __shfl_xor(v, o);
    return v;
}

__global__ void __launch_bounds__(256) k_mod(const float* __restrict__ c, const float* __restrict__ ada_w, const float* __restrict__ ada_b, float* __restrict__ mod) {
    __shared__ float sc[NB * D];
    const int tid = threadIdx.x, e = blockIdx.x * 256 + tid, l = blockIdx.y;
    for (int i = tid; i < NB * D; i += 256) sc[i] = siluf(c[i]);
    __syncthreads();
    float acc[NB];
#pragma unroll
    for (int b = 0; b < NB; ++b) acc[b] = 0.f;
    const float* w = ada_w + (size_t)l * D * 3 * D + e;
    for (int d = 0; d < D; ++d) {
        const float wv = w[(size_t)d * 3 * D];
#pragma unroll
        for (int b = 0; b < NB; ++b) acc[b] += sc[b * D + d] * wv;
    }
#pragma unroll
    for (int b = 0; b < NB; ++b) mod[((size_t)l * NB + b) * 3 * D + e] = acc[b] + ada_b[l * 3 * D + e];
}

__global__ void __launch_bounds__(256) k_prenorm(const float* __restrict__ x, const float* __restrict__ wpre, const float* __restrict__ modl, float* __restrict__ h, int row0) {
    __shared__ float red[4];
    const int tid = threadIdx.x, r = blockIdx.x, row = row0 + r, b = row / S;
    const float4 v = *(const float4*)(x + (size_t)row * D + tid * 4);
    float ss = v.x * v.x + v.y * v.y + v.z * v.z + v.w * v.w;
    ss = wave_sum(ss);
    if ((tid & 63) == 0) red[tid >> 6] = ss;
    __syncthreads();
    const float tot = red[0] + red[1] + red[2] + red[3];
    const float rstd = rsqrtf(tot * (1.f / D) + EPS);
    const float4 w = *(const float4*)(wpre + tid * 4);
    const float4 sh = *(const float4*)(modl + (size_t)b * 3 * D + tid * 4);
    const float4 sc = *(const float4*)(modl + (size_t)b * 3 * D + D + tid * 4);
    float4 o;
    o.x = v.x * rstd * w.x * (1.f + sc.x) + sh.x; o.y = v.y * rstd * w.y * (1.f + sc.y) + sh.y;
    o.z = v.z * rstd * w.z * (1.f + sc.z) + sh.z; o.w = v.w * rstd * w.w * (1.f + sc.w) + sh.w;
    *(float4*)(h + (size_t)r * D + tid * 4) = o;
}

__global__ void __launch_bounds__(256) k_gemm(const float* __restrict__ A, const float* __restrict__ Bw, float* __restrict__ C, int N, int K) {
    __shared__ float As[16][64 + 4];
    __shared__ float Bs[16][64 + 4];
    const int tid = threadIdx.x, tx = tid & 15, ty = tid >> 4;
    const int m0 = blockIdx.y * 64, n0 = blockIdx.x * 64;
    float acc[4][4];
#pragma unroll
    for (int i = 0; i < 4; ++i)
#pragma unroll
        for (int j = 0; j < 4; ++j) acc[i][j] = 0.f;
    for (int k0 = 0; k0 < K; k0 += 16) {
        {
            const int r = tid >> 2, kk = (tid & 3) * 4;
            const float4 a = *(const float4*)(A + (size_t)(m0 + r) * K + k0 + kk);
            As[kk + 0][r] = a.x; As[kk + 1][r] = a.y; As[kk + 2][r] = a.z; As[kk + 3][r] = a.w;
        }
        {
            const int kk = tid >> 4, nn = (tid & 15) * 4;
#pragma unroll
            for (int j = 0; j < 4; ++j) { const int n = n0 + nn + j; Bs[kk][nn + j] = (n < N) ? Bw[(size_t)(k0 + kk) * N + n] : 0.f; }
        }
        __syncthreads();
#pragma unroll
        for (int kk = 0; kk < 16; ++kk) {
            float a[4], b[4];
#pragma unroll
            for (int i = 0; i < 4; ++i) a[i] = As[kk][ty * 4 + i];
#pragma unroll
            for (int j = 0; j < 4; ++j) b[j] = Bs[kk][tx * 4 + j];
#pragma unroll
            for (int i = 0; i < 4; ++i)
#pragma unroll
                for (int j = 0; j < 4; ++j) acc[i][j] += a[i] * b[j];
        }
        __syncthreads();
    }
#pragma unroll
    for (int i = 0; i < 4; ++i)
#pragma unroll
        for (int j = 0; j < 4; ++j) { const int n = n0 + tx * 4 + j; if (n < N) C[(size_t)(m0 + ty * 4 + i) * N + n] = acc[i][j]; }
}

__global__ void __launch_bounds__(256) k_rope(float* __restrict__ P, int ld, int col0, int nh, const int* __restrict__ pos, int row0, Rope rp) {
    const int idx = blockIdx.x * 256 + threadIdx.x;
    const int i = idx & 7, hd = (idx >> 3) % nh, r = (idx >> 3) / nh;
    if (r >= CH_M) return;
    const float ang = (float)pos[row0 + r] * rp.f[i];
    const float cs = cosf(ang), sn = sinf(ang);
    float* p = P + (size_t)r * ld + col0 + hd * 64;
    const float t1 = p[i], t2 = p[i + 8];
    p[i] = t1 * cs - t2 * sn; p[i + 8] = t2 * cs + t1 * sn;
}

__global__ void k_fcum(const float* __restrict__ P, const float* __restrict__ bfg, float* __restrict__ F) {
    const int idx = threadIdx.x;
    if (idx >= CH_B * 8) return;
    const int bl = idx >> 3, h = idx & 7;
    float acc = 0.f; const float bf = bfg[h];
    for (int s = 0; s < S; ++s) {
        const float v = P[(size_t)(bl * S + s) * EV_IN + 1536 + h] + bf;
        const float ls = fminf(v, 0.f) - log1pf(expf(-fabsf(v)));
        acc += ls; F[(size_t)idx * S + s] = acc;
    }
}

template <int DV, int MODE>
__global__ void __launch_bounds__(64) k_attn(const float* __restrict__ P, int qcol, int kcol, int vcol, int nh, int qk_hs, int v_hs,
                                             const float* __restrict__ F, float* __restrict__ out, int out_ld, int out_col, int gcol) {
    const int lane = threadIdx.x, t = blockIdx.x * 64 + lane, ph = blockIdx.y, bl = ph / nh, h = ph % nh;
    const float* base = P + (size_t)bl * S * EV_IN;
    const float* Qp = base + (size_t)t * EV_IN + qcol + h * qk_hs;
    float q[64];
#pragma unroll
    for (int d = 0; d < 64; ++d) q[d] = Qp[d] * 0.125f;
    float o[DV];
#pragma unroll
    for (int e = 0; e < DV; ++e) o[e] = 0.f;
    float m = -INFINITY, l = 0.f;
    const float* Fp = (MODE == 0) ? (F + (size_t)ph * S) : nullptr;
    const float Ft = (MODE == 0) ? Fp[t] : 0.f;
    const int tmax = blockIdx.x * 64 + 63;
    for (int s = 0; s <= tmax; ++s) {
        const float* kr = base + (size_t)s * EV_IN + kcol + h * qk_hs;
        const float* vr = base + (size_t)s * EV_IN + vcol + h * v_hs;
        float sc = 0.f;
#pragma unroll
        for (int d = 0; d < 64; ++d) sc += q[d] * kr[d];
        if (MODE == 0) sc += Ft - Fp[s];
        if (s <= t) {
            const float mn = fmaxf(m, sc), a = expf(m - mn), p = expf(sc - mn);
            l = l * a + p; m = mn;
#pragma unroll
            for (int e = 0; e < DV; ++e) o[e] = o[e] * a + p * vr[e];
        }
    }
    const float il = 1.f / l;
    const size_t row = (size_t)bl * S + t;
    if (MODE == 0) {
        const float* g = base + (size_t)t * EV_IN + gcol + h * 64;
#pragma unroll
        for (int e = 0; e < DV; ++e) out[row * out_ld + out_col + h * DV + e] = o[e] * il * siluf(g[e]);
    } else {
#pragma unroll
        for (int e = 0; e < DV; ++e) out[row * out_ld + out_col + h * DV + e] = o[e] * il;
    }
}

__global__ void __launch_bounds__(256) k_diffcomb(const float* __restrict__ On  , const float* __restrict__ P, const float* __restrict__ lq1, const float* __restrict__ lk1,
                                                  const float* __restrict__ lq2, const float* __restrict__ lk2, const float* __restrict__ subln, float lam_init, float* __restrict__ cat) {
    const int lane = threadIdx.x & 63, w = blockIdx.x * 4 + (threadIdx.x >> 6);
    const int r = w >> 2, hd = w & 3;
    const float s1 = wave_sum(lq1[lane] * lk1[lane]), s2 = wave_sum(lq2[lane] * lk2[lane]);
    const float lam = expf(s1) - expf(s2) + lam_init;
    const float* o1 = On + (size_t)r * 512 + hd * 128; const float* o2 = On + (size_t)CH_M * 512 + (size_t)r * 512 + hd * 128;
    const float d0 = o1[lane] - lam * o2[lane], d1 = o1[lane + 64] - lam * o2[lane + 64];
    const float ss = wave_sum(d0 * d0 + d1 * d1);
    const float rstd = rsqrtf(ss * (1.f / 128.f) + EPS);
    const float* g = P + (size_t)r * EV_IN + 3592 + hd * 128;
    cat[(size_t)r * D + 512 + hd * 128 + lane] = d0 * rstd * subln[lane] * (1.f - lam_init) * siluf(g[lane]);
    cat[(size_t)r * D + 512 + hd * 128 + lane + 64] = d1 * rstd * subln[lane + 64] * (1.f - lam_init) * siluf(g[lane + 64]);
}

__global__ void __launch_bounds__(64) k_dil(const float* __restrict__ P, float* __restrict__ cat) {
    const int lane = threadIdx.x, t = blockIdx.x * 64 + lane, ph = blockIdx.y, bl = ph >> 4, h = ph & 15;
    const float* base = P + (size_t)bl * S * OD_IN;
    const float* Qp = base + (size_t)t * OD_IN + h * 64;
    float q[64];
#pragma unroll
    for (int d = 0; d < 64; ++d) q[d] = Qp[d] * 0.125f;
    float o[64];
#pragma unroll
    for (int e = 0; e < 64; ++e) o[e] = 0.f;
    float m = -INFINITY, l = 0.f;
    for (int br = 0; br < 3; ++br) {
        const int dil = (br == 0) ? 1 : (br == 1) ? 4 : 16;
        for (int j = 0; j <= 128; ++j) {
            const int s = t - j * dil;
            if (s >= 0) {
                const float4* kr = (const float4*)(base + (size_t)s * OD_IN + 1024 + h * 64);
                const float4* vr = (const float4*)(base + (size_t)s * OD_IN + 2048 + h * 64);
                float sc = 0.f;
#pragma unroll
                for (int d = 0; d < 16; ++d) { const float4 kv = kr[d]; sc += q[4 * d] * kv.x + q[4 * d + 1] * kv.y + q[4 * d + 2] * kv.z + q[4 * d + 3] * kv.w; }
                const float mn = fmaxf(m, sc), a = expf(m - mn), p = expf(sc - mn);
                l = l * a + p; m = mn;
#pragma unroll
                for (int e = 0; e < 16; ++e) { const float4 vv = vr[e]; o[4 * e] = o[4 * e] * a + p * vv.x; o[4 * e + 1] = o[4 * e + 1] * a + p * vv.y; o[4 * e + 2] = o[4 * e + 2] * a + p * vv.z; o[4 * e + 3] = o[4 * e + 3] * a + p * vv.w; }
            }
        }
    }
    const float il = 1.f / l;
    const float* g = base + (size_t)t * OD_IN + 3072 + h * 64;
    float* op = cat + ((size_t)bl * S + t) * D + h * 64;
#pragma unroll
    for (int e = 0; e < 64; ++e) op[e] = o[e] * il * siluf(g[e]);
}

__global__ void __launch_bounds__(256) k_postnorm(float* __restrict__ x, const float* __restrict__ y, const float* __restrict__ wpost, const float* __restrict__ modl, int row0) {
    __shared__ float red[4];
    const int tid = threadIdx.x, r = blockIdx.x, row = row0 + r, b = row / S;
    const float4 v = *(const float4*)(y + (size_t)r * D + tid * 4);
    float ss = v.x * v.x + v.y * v.y + v.z * v.z + v.w * v.w;
    ss = wave_sum(ss);
    if ((tid & 63) == 0) red[tid >> 6] = ss;
    __syncthreads();
    const float tot = red[0] + red[1] + red[2] + red[3];
    const float rstd = rsqrtf(tot * (1.f / D) + EPS);
    const float4 w = *(const float4*)(wpost + tid * 4);
    const float4 g = *(const float4*)(modl + (size_t)b * 3 * D + 2 * D + tid * 4);
    float4 xv = *(float4*)(x + (size_t)row * D + tid * 4);
    xv.x += g.x * v.x * rstd * w.x; xv.y += g.y * v.y * rstd * w.y; xv.z += g.z * v.z * rstd * w.z; xv.w += g.w * v.w * rstd * w.w;
    *(float4*)(x + (size_t)row * D + tid * 4) = xv;
}
}

extern "C" void kernel_launch(void* const* d_in, const int* in_sizes, int n_in, void* d_out, int out_size, void* d_ws, size_t ws_size, hipStream_t stream) {
    const float* x = (const float*)d_in[0]; const float* c = (const float*)d_in[1]; const int* pos = (const int*)d_in[2];
    const float* norm_pre = (const float*)d_in[3]; const float* norm_post = (const float*)d_in[4];
    const float* ada_w = (const float*)d_in[5]; const float* ada_b = (const float*)d_in[6];
    const float* ev_w_in = (const float*)d_in[7]; const float* ev_bf = (const float*)d_in[8];
    const float* lq1 = (const float*)d_in[9]; const float* lk1 = (const float*)d_in[10]; const float* lq2 = (const float*)d_in[11]; const float* lk2 = (const float*)d_in[12];
    const float* subln = (const float*)d_in[13]; const float* ev_w_out = (const float*)d_in[14];
    const float* od_w_in = (const float*)d_in[15]; const float* od_w_out = (const float*)d_in[16];
    float* out = (float*)d_out;
    char* ws = (char*)d_ws;
    size_t off = 0;
    auto carve = [&](size_t bytes) { char* p = ws + off; off += (bytes + 255) & ~(size_t)255; return p; };
    float* mod = (float*)carve((size_t)NL * NB * 3 * D * 4);
    float* h = (float*)carve((size_t)CH_M * D * 4);
    float* proj = (float*)carve((size_t)CH_M * EV_IN * 4);
    float* cat = (float*)carve((size_t)CH_M * D * 4);
    float* y = (float*)carve((size_t)CH_M * D * 4);
    float* On = (float*)carve((size_t)2 * CH_M * 512 * 4);
    float* F = (float*)carve((size_t)CH_B * 8 * S * 4);
    if (off > ws_size) { fprintf(stderr, "workspace too small\n"); return; }
    Rope rp; for (int i = 0; i < 8; ++i) rp.f[i] = (float)(1.0 / pow(500000.0, (double)i / 8.0));

    hipMemcpyAsync(out, x, (size_t)M * D * 4, hipMemcpyDeviceToDevice, stream);
    k_mod<<<dim3(3 * D / 256, NL), 256, 0, stream>>>(c, ada_w, ada_b, mod);
    for (int l = 0; l < NL; ++l) {
        const float* modl = mod + (size_t)l * NB * 3 * D;
        const int i = l / 2;
        for (int ch = 0; ch < NB / CH_B; ++ch) {
            const int row0 = ch * CH_M;
            k_prenorm<<<CH_M, 256, 0, stream>>>(out, norm_pre + l * D, modl, h, row0);
            if ((l & 1) == 0) {
                k_gemm<<<dim3((EV_IN + 63) / 64, CH_M / 64), 256, 0, stream>>>(h, ev_w_in + (size_t)i * D * EV_IN, proj, EV_IN, D);
                k_rope<<<(CH_M * 16 * 8) / 256, 256, 0, stream>>>(proj, EV_IN, 2056, 16, pos, row0, rp);
                k_fcum<<<1, 64, 0, stream>>>(proj, ev_bf + i * 8, F);
                k_attn<64, 0><<<dim3(S / 64, CH_B * 8), 64, 0, stream>>>(proj, 0, 512, 1024, 8, 64, 64, F, cat, D, 0, 1544);
                for (int mp = 0; mp < 2; ++mp)
                    k_attn<128, 1><<<dim3(S / 64, CH_B * 4), 64, 0, stream>>>(proj, 2056 + mp * 64, 2568 + mp * 64, 3080, 4, 128, 128, nullptr, On + (size_t)mp * CH_M * 512, 512, 0, 0);
                const float lam_init = (float)(0.8 - 0.6 * exp(-0.3 * (double)l));
                k_diffcomb<<<CH_M, 256, 0, stream>>>(On, proj, lq1 + i * 64, lk1 + i * 64, lq2 + i * 64, lk2 + i * 64, subln + i * 128, lam_init, cat);
                k_gemm<<<dim3(D / 64, CH_M / 64), 256, 0, stream>>>(cat, ev_w_out + (size_t)i * D * D, y, D, D);
            } else {
                k_gemm<<<dim3(OD_IN / 64, CH_M / 64), 256, 0, stream>>>(h, od_w_in + (size_t)i * D * OD_IN, proj, OD_IN, D);
                k_rope<<<(CH_M * 32 * 8) / 256, 256, 0, stream>>>(proj, OD_IN, 0, 32, pos, row0, rp);
                k_dil<<<dim3(S / 64, CH_B * 16), 64, 0, stream>>>(proj, cat);
                k_gemm<<<dim3(D / 64, CH_M / 64), 256, 0, stream>>>(cat, od_w_out + (size_t)i * D * D, y, D, D);
            }
            k_postnorm<<<CH_M, 256, 0, stream>>>(out, y, norm_post + l * D, modl, row0);
        }
    }
}
```
